# Optimizing an MI355X kernel written in HIP

```python
import jax, jax.numpy as jnp
from jax import lax
import numpy as np

D_MODEL = 1024
BATCH = 4
SEQ = 4096
DEPTH = 4

HEAD_DIM = 64
ATTN_WIDTH = D_MODEL // 2
CONV_WIDTH = D_MODEL - ATTN_WIDTH
N_ATTN_HEADS = ATTN_WIDTH // HEAD_DIM
N_CONV_GROUPS = CONV_WIDTH // HEAD_DIM
IN_PROJ_WIDTH = 3 * ATTN_WIDTH + 3 * CONV_WIDTH
CONV_K = 3
ROPE_DIM = HEAD_DIM // 4
ROPE_THETA = 500000.0
DILATED_BRANCHES = ((128, 1), (512, 4), (2048, 16))
FFN_HIDDEN = ((8 * D_MODEL // 3 + 255) // 256) * 256
RMS_EPS = 1e-6
NEG_INF = -1e30

kernel_name = "hybrid_dilated_attn_shortconv_encoder"


def rms_norm(x, g):
    xf = x.astype(jnp.float32)
    y = xf * lax.rsqrt(jnp.mean(xf * xf, axis=-1, keepdims=True) + RMS_EPS)
    return (y * g.astype(jnp.float32)).astype(x.dtype)


def rotary_tables(positions):
    inv_freq = ROPE_THETA ** (-jnp.arange(0, ROPE_DIM, 2, dtype=jnp.float32) / ROPE_DIM)
    ang = positions.astype(jnp.float32)[..., None] * inv_freq
    return jnp.cos(ang)[:, None], jnp.sin(ang)[:, None]


def apply_partial_rotary(t, cos, sin):
    tf = t.astype(jnp.float32)
    half = ROPE_DIM // 2
    t1 = tf[..., :half]
    t2 = tf[..., half:ROPE_DIM]
    out = jnp.concatenate([t1 * cos - t2 * sin, t2 * cos + t1 * sin, tf[..., ROPE_DIM:]], axis=-1)
    return out.astype(t.dtype)


def banded_attention(q, k, v, half):
    L, dh = q.shape[-2], q.shape[-1]
    lead = q.shape[:-2]
    nb = -(-L // half)
    lp = nb * half
    pad_q = [(0, 0)] * len(lead) + [(0, lp - L), (0, 0)]
    pad_kv = [(0, 0)] * len(lead) + [(half, lp - L + half), (0, 0)]
    qb = jnp.pad(q, pad_q).reshape(*lead, nb, half, dh).astype(jnp.float32)

    def windows(t):
        tb = jnp.pad(t, pad_kv).reshape(*lead, nb + 2, half, dh).astype(jnp.float32)
        return jnp.concatenate([tb[..., :-2, :, :], tb[..., 1:-1, :, :], tb[..., 2:, :, :]], axis=-2)

    kw = windows(k)
    vw = windows(v)
    s = jnp.einsum('...nqd,...nkd->...nqk', qb, kw) * (dh ** -0.5)
    qi = jnp.arange(nb)[:, None] * half + jnp.arange(half)[None, :]
    ki = jnp.arange(nb)[:, None] * half + jnp.arange(3 * half)[None, :] - half
    valid = (jnp.abs(qi[:, :, None] - ki[:, None, :]) <= half) & ((ki >= 0) & (ki < L))[:, None, :]
    s = jnp.where(valid, s, NEG_INF)
    lse = jax.nn.logsumexp(s, axis=-1)
    p = jnp.exp(s - lse[..., None])
    o = jnp.einsum('...nqk,...nkd->...nqd', p, vw)
    o = o.reshape(*lead, lp, dh)[..., :L, :]
    lse = lse.reshape(*lead, lp)[..., :L]
    return o, lse


def dilated_mixture_attention(q, k, v):
    b, h, s, dh = q.shape
    outs, lses = [], []
    for window, dil in DILATED_BRANCHES:
        L = s // dil
        half = window // (2 * dil)

        def by_residue(t):
            return t.reshape(b, h, L, dil, dh).swapaxes(2, 3)

        o, lse = banded_attention(by_residue(q), by_residue(k), by_residue(v), half)
        outs.append(o.swapaxes(2, 3).reshape(b, h, s, dh))
        lses.append(lse.swapaxes(2, 3).reshape(b, h, s))
    w = jax.nn.softmax(jnp.stack(lses, axis=0), axis=0)
    o = jnp.sum(w[..., None] * jnp.stack(outs, axis=0), axis=0)
    return o.astype(q.dtype)


def short_conv(u, w):
    c = u.shape[-1]
    return lax.conv_general_dilated(
        u, w.reshape(CONV_K, 1, c).astype(u.dtype), window_strides=(1,),
        padding=[(CONV_K // 2, CONV_K // 2)], dimension_numbers=('NWC', 'WIO', 'NWC'),
        feature_group_count=c)


def setup_inputs(seed: int = 0) -> dict:
    key = jax.random.key(seed)
    ks = jax.random.split(key, 16)
    f32 = jnp.float32

    def gain(k, shape):
        return 1.0 + 0.02 * jax.random.normal(k, shape, f32)

    x = jax.random.normal(ks[0], (BATCH, SEQ, D_MODEL), f32)
    offsets = jax.random.randint(ks[1], (BATCH, 1), 0, 1024, dtype=jnp.int32)
    positions = (jnp.arange(SEQ, dtype=jnp.int32)[None, :] + offsets).astype(jnp.int32)
    return {
        "x": x,
        "positions": positions,
        "pre_mix_norm": gain(ks[2], (DEPTH, D_MODEL)),
        "w_in": jax.random.normal(ks[3], (DEPTH, D_MODEL, IN_PROJ_WIDTH), f32) * D_MODEL ** -0.5,
        "conv_w": jax.random.normal(ks[4], (DEPTH, CONV_K, CONV_WIDTH), f32) * CONV_K ** -0.5,
        "attn_out_norm": gain(ks[5], (DEPTH, ATTN_WIDTH)),
        "conv_out_norm": gain(ks[6], (DEPTH, CONV_WIDTH)),
        "w_out": jax.random.normal(ks[7], (DEPTH, D_MODEL, D_MODEL), f32) * D_MODEL ** -0.5,
        "post_mix_norm": gain(ks[8], (DEPTH, D_MODEL)),
        "pre_ffn_norm": gain(ks[9], (DEPTH, D_MODEL)),
        "w_gate_up": jax.random.normal(ks[10], (DEPTH, D_MODEL, 2 * FFN_HIDDEN), f32) * D_MODEL ** -0.5,
        "w_down": jax.random.normal(ks[11], (DEPTH, FFN_HIDDEN, D_MODEL), f32) * FFN_HIDDEN ** -0.5,
        "post_ffn_norm": gain(ks[12], (DEPTH, D_MODEL)),
    }


def reference(x, positions, pre_mix_norm, w_in, conv_w, attn_out_norm, conv_out_norm,
              w_out, post_mix_norm, pre_ffn_norm, w_gate_up, w_down, post_ffn_norm):
    b, s, _ = x.shape
    cos, sin = rotary_tables(positions)
    split_points = np.cumsum([ATTN_WIDTH] * 3 + [CONV_WIDTH] * 2).tolist()

    def heads(t):
        return t.reshape(b, s, N_ATTN_HEADS, HEAD_DIM).transpose(0, 2, 1, 3)

    for l in range(DEPTH):
        h = rms_norm(x, pre_mix_norm[l])
        proj = jnp.einsum('bsd,de->bse', h, w_in[l])
        q, k, v, conv_u, gate_b, gate_c = jnp.split(proj, split_points, axis=-1)
        q = apply_partial_rotary(heads(q), cos, sin)
        k = apply_partial_rotary(heads(k), cos, sin)
        attn = dilated_mixture_attention(q, k, heads(v))
        attn = attn.transpose(0, 2, 1, 3).reshape(b, s, ATTN_WIDTH)
        conv_y = gate_b * short_conv(gate_c * conv_u, conv_w[l])
        merged = jnp.concatenate([rms_norm(attn, attn_out_norm[l]),
                                  rms_norm(conv_y, conv_out_norm[l])], axis=-1)
        mix = jnp.einsum('bse,ed->bsd', merged, w_out[l])
        x = x + rms_norm(mix, post_mix_norm[l])
        h = rms_norm(x, pre_ffn_norm[l])
        g, u = jnp.split(jnp.einsum('bsd,df->bsf', h, w_gate_up[l]), 2, axis=-1)
        f = jnp.einsum('bsf,fd->bsd', jax.nn.silu(g) * u, w_down[l])
        x = x + rms_norm(f, post_ffn_norm[l])
    return x
```

```cpp
#include <hip/hip_runtime.h>
#include <cstdio>
#include <cstdint>

typedef unsigned short bf16_t;
typedef short bf16x8 __attribute__((ext_vector_type(8)));
typedef float f32x4 __attribute__((ext_vector_type(4)));
typedef unsigned u32x4 __attribute__((ext_vector_type(4)));
typedef unsigned u32x2 __attribute__((ext_vector_type(2)));

constexpr int D = 1024, BATCH = 4, SEQ = 4096, DEPTH = 4, M = BATCH * SEQ;
constexpr int HD = 64, AW = 512, CW = 512, NH = 8, NIN = 3072, FF = 2816, NGU = 2 * FF;
constexpr float RMS_EPS = 1e-6f;
constexpr float QSCALE = 0.125f * 1.4426950408889634f;

constexpr size_t MiB = 1u << 20;
constexpr size_t WS_CTL = 0;
constexpr size_t WS_ROT = 1 * MiB;
constexpr size_t WS_WIN = 2 * MiB;
constexpr size_t WS_WOUT = 26 * MiB;
constexpr size_t WS_WGU = 34 * MiB;
constexpr size_t WS_WDN = 78 * MiB;
constexpr size_t WS_XN = 100 * MiB;
constexpr size_t WS_MG = 132 * MiB;
constexpr size_t WS_P = 164 * MiB;
constexpr size_t WS_H = WS_P;
constexpr size_t WS_TMP = 260 * MiB;
constexpr size_t WS_END = 324 * MiB;

__device__ __forceinline__ unsigned f2bf(float f) { unsigned u = __builtin_bit_cast(unsigned, f); return (u + 0x7fffu + ((u >> 16) & 1u)) >> 16; }
__device__ __forceinline__ unsigned pk2(float lo, float hi) { return f2bf(lo) | (f2bf(hi) << 16); }
__device__ __forceinline__ float bf2f(unsigned short b) { return __builtin_bit_cast(float, (unsigned)b << 16); }
__device__ __forceinline__ float wave_sum(float v) {
#pragma unroll
    for (int o = 1; o < 64; o <<= 1) v += __shfl_xor(v, o);
    return v;
}

__device__ __forceinline__ void transpose_item(const float* W, int K, int Nsrc, bf16_t* Bt, const float* g0, const float* g1, int gsplit, bool gu, float* scr, int item, int lane, int Ndst) {
    const int nblk = Ndst / 32, kb = item / nblk, nb = item % nblk, k0 = 64 * kb, n0 = 32 * nb;
    int s0 = n0;
    if (gu) { const int t = n0 >> 8, j = n0 & 255; s0 = (j < 128) ? (128 * t + j) : (FF + 128 * t + (j - 128)); }
#pragma unroll 8
    for (int i = 0; i < 32; ++i) { const int kk = 2 * i + (lane >> 5); const int k = k0 + kk;
        float gv = 1.f; if (g0) gv = (k < gsplit) ? g0[k] : g1[k - gsplit];
        scr[kk * 33 + (lane & 31)] = W[(size_t)k * Nsrc + s0 + (lane & 31)] * gv; }
    asm volatile("s_waitcnt lgkmcnt(0)" ::: "memory");
    const int c = lane & 7;
#pragma unroll
    for (int j = 0; j < 4; ++j) { const int n = (lane >> 3) + 8 * j; const float* s = scr + (8 * c) * 33 + n;
        u32x4 o; o.x = pk2(s[0 * 33], s[1 * 33]); o.y = pk2(s[2 * 33], s[3 * 33]); o.z = pk2(s[4 * 33], s[5 * 33]); o.w = pk2(s[6 * 33], s[7 * 33]);
        *(u32x4*)(Bt + (size_t)(n0 + n) * K + k0 + 8 * c) = o; }
    asm volatile("s_waitcnt lgkmcnt(0)" ::: "memory");
}

struct Ptrs {
    const float* x; const int* pos; const float* pre_mix; const float* w_in; const float* conv_w; const float* attn_norm; const float* conv_norm;
    const float* w_out; const float* post_mix; const float* pre_ffn; const float* w_gu; const float* w_dn; const float* post_ffn;
    float* out; unsigned char* ws;
};

__global__ void __launch_bounds__(512) k_prep(Ptrs p) {
    __shared__ float scr_all[8 * 64 * 33];
    const int tid = threadIdx.x, lane = tid & 63, wave = tid >> 6;
    float* scr = scr_all + wave * 64 * 33;
    const int gw = blockIdx.x * 8 + wave, NGW = gridDim.x * 8;
    constexpr int I_IN = (D / 64) * (NIN / 32), I_OUT = (D / 64) * (D / 32), I_GU = (D / 64) * (NGU / 32), I_DN = (FF / 64) * (D / 32);
    constexpr int I_L = I_IN + I_OUT + I_GU + I_DN;
    bf16_t* win = (bf16_t*)(p.ws + WS_WIN); bf16_t* wout = (bf16_t*)(p.ws + WS_WOUT); bf16_t* wgu = (bf16_t*)(p.ws + WS_WGU); bf16_t* wdn = (bf16_t*)(p.ws + WS_WDN);
    for (int it = gw; it < DEPTH * I_L; it += NGW) {
        const int l = it / I_L; int r = it % I_L;
        if (r < I_IN) { transpose_item(p.w_in + (size_t)l * D * NIN, D, NIN, win + (size_t)l * NIN * D, p.pre_mix + l * D, p.pre_mix + l * D, D, false, scr, r, lane, NIN); continue; } r -= I_IN;
        if (r < I_OUT) { transpose_item(p.w_out + (size_t)l * D * D, D, D, wout + (size_t)l * D * D, p.attn_norm + l * AW, p.conv_norm + l * CW, AW, false, scr, r, lane, D); continue; } r -= I_OUT;
        if (r < I_GU) { transpose_item(p.w_gu + (size_t)l * D * NGU, D, NGU, wgu + (size_t)l * NGU * D, p.pre_ffn + l * D, p.pre_ffn + l * D, D, true, scr, r, lane, NGU); continue; } r -= I_GU;
        transpose_item(p.w_dn + (size_t)l * FF * D, FF, D, wdn + (size_t)l * D * FF, nullptr, nullptr, 0, false, scr, r, lane, D);
    }
    float* rot = (float*)(p.ws + WS_ROT);
    for (int e = blockIdx.x * 512 + tid; e < M * 8; e += gridDim.x * 512) {
        const int tok = e >> 3, i = e & 7;
        const double inv = exp2(-(double)i * (18.931568569324174 / 8.0));
        const double ang = (double)p.pos[tok] * inv;
        const double n = rint(ang * 0.15915494309189535);
        const double red = fma(-n, 1.2246467991473532e-16 * 2.0, fma(-n, 6.283185307179586, ang));
        const float rf = (float)red;
        rot[tok * 16 + i] = cosf(rf); rot[tok * 16 + 8 + i] = sinf(rf);
    }
    bf16_t* xn = (bf16_t*)(p.ws + WS_XN);
    for (int m = gw; m < M; m += NGW) {
        const f32x4* xr = (const f32x4*)(p.x + (size_t)m * D) + lane;
        f32x4 v[4]; float s = 0.f;
#pragma unroll
        for (int j = 0; j < 4; ++j) { v[j] = xr[64 * j]; s += (v[j].x * v[j].x + v[j].y * v[j].y) + (v[j].z * v[j].z + v[j].w * v[j].w); }
        const float rstd = 1.f / sqrtf(wave_sum(s) * (1.f / D) + RMS_EPS);
        unsigned long long* o8 = (unsigned long long*)(xn + (size_t)m * D) + lane;
#pragma unroll
        for (int j = 0; j < 4; ++j) o8[64 * j] = (unsigned long long)pk2(v[j].x * rstd, v[j].y * rstd) | ((unsigned long long)pk2(v[j].z * rstd, v[j].w * rstd) << 32);
    }
}

struct EpiInProjN {
    bf16_t* P; const float* rot;
    __device__ void operator()(f32x4 (&acc)[2], int row0, int col0, int lane) const {
        const int c = lane & 15, q = lane >> 4, col = col0 + c;
        const bool isq = col < AW, isk = (col >= AW && col < 2 * AW);
#pragma unroll
        for (int j = 0; j < 4; ++j) { const int row = row0 + 4 * q + j; float v = acc[0][j];
            const float partner = __shfl_xor(v, 8);
            if (isq || isk) { const int d = col & 63;
                if (d < 16) { const int i = d & 7; const float cs = rot[row * 16 + i], sn = rot[row * 16 + 8 + i];
                    v = (d < 8) ? (v * cs - partner * sn) : (v * cs + partner * sn); }
                if (isq) v *= QSCALE; }
            P[(size_t)row * NIN + col] = (bf16_t)f2bf(v); }
    }
};
struct EpiF32N {
    float* C;
    __device__ void operator()(f32x4 (&acc)[2], int row0, int col0, int lane) const {
        const int c = lane & 15, q = lane >> 4;
#pragma unroll
        for (int j = 0; j < 4; ++j) C[(size_t)(row0 + 4 * q + j) * D + col0 + c] = acc[0][j];
    }
};
struct EpiSwigluN {
    bf16_t* H;
    __device__ void operator()(f32x4 (&acc)[2], int row0, int col0, int lane) const {
        const int c = lane & 15, q = lane >> 4; const int t = col0 >> 8, j0 = col0 & 255; const int hcol = 128 * t + j0 + c;
#pragma unroll
        for (int j = 0; j < 4; ++j) { const float g = acc[0][j], u = acc[1][j]; const float s = g / (1.f + __expf(-g));
            H[(size_t)(row0 + 4 * q + j) * FF + hcol] = (bf16_t)f2bf(s * u); }
    }
};
template <class Epi, int NT>
__global__ void __launch_bounds__(256) k_gemm_naive(const bf16_t* A, const bf16_t* Bt, int N, int K, Epi E) {
    const int lane = threadIdx.x & 63, wave = threadIdx.x >> 6;
    const int ntn = (NT == 2) ? (N / 256) * 8 : N / 16;
    const long wid = (long)blockIdx.x * 4 + wave;
    const int tm = (int)(wid / ntn), tn = (int)(wid % ntn);
    if (tm >= M / 16) return;
    const int row0 = tm * 16, col0 = (NT == 2) ? ((tn >> 3) * 256 + (tn & 7) * 16) : tn * 16;
    const int r = lane & 15, q = lane >> 4;
    f32x4 acc[2] = {{0.f, 0.f, 0.f, 0.f}, {0.f, 0.f, 0.f, 0.f}};
    const bf16_t* ap = A + (size_t)(row0 + r) * K + q * 8;
    const bf16_t* bp = Bt + (size_t)(col0 + r) * K + q * 8;
    for (int k0 = 0; k0 < K; k0 += 32) {
        const bf16x8 a = *(const bf16x8*)(ap + k0);
        const bf16x8 b0 = *(const bf16x8*)(bp + k0);
        acc[0] = __builtin_amdgcn_mfma_f32_16x16x32_bf16(a, b0, acc[0], 0, 0, 0);
        if (NT == 2) { const bf16x8 b1 = *(const bf16x8*)(bp + (size_t)128 * K + k0); acc[1] = __builtin_amdgcn_mfma_f32_16x16x32_bf16(a, b1, acc[1], 0, 0, 0); }
    }
    E(acc, row0, col0, lane);
}

__global__ void __launch_bounds__(256) k_attn_naive(const bf16_t* P, bf16_t* AT  ) {
    const int gid = blockIdx.x * 256 + threadIdx.x;
    if (gid >= M * NH) return;
    const int h = gid / M, tok = gid % M, b = tok / SEQ, i = tok % SEQ;
    float q[64], o[64];
    const bf16_t* qp = P + (size_t)tok * NIN + h * 64;
#pragma unroll
    for (int d = 0; d < 64; ++d) { q[d] = bf2f(qp[d]); o[d] = 0.f; }
    float mx = -1e30f, l = 0.f;
    for (int br = 0; br < 3; ++br) { const int dil = 1 << (2 * br);
        for (int j = -64; j <= 64; ++j) { const int kpos = i + dil * j; if (kpos < 0 || kpos >= SEQ) continue;
            const bf16_t* kp = P + (size_t)(b * SEQ + kpos) * NIN + AW + h * 64; const bf16_t* vp = kp + AW;
            float s = 0.f;
#pragma unroll
            for (int d = 0; d < 64; ++d) s += q[d] * bf2f(kp[d]);
            const float mn = fmaxf(mx, s), f = exp2f(mx - mn), pe = exp2f(s - mn);
            l = l * f + pe;
#pragma unroll
            for (int d = 0; d < 64; ++d) o[d] = o[d] * f + pe * bf2f(vp[d]);
            mx = mn; } }
    const float il = 1.f / l;
    bf16_t* op = AT + (size_t)tok * AW + h * 64;
#pragma unroll
    for (int d = 0; d < 64; ++d) op[d] = (bf16_t)f2bf(o[d] * il);
}

__global__ void __launch_bounds__(256) k_merge(const bf16_t* P, const bf16_t* AT, const float* convw  , bf16_t* MG) {
    const int lane = threadIdx.x & 63, tok = blockIdx.x * 4 + (threadIdx.x >> 6);
    if (tok >= M) return;
    const int i = tok % SEQ;
    { const bf16x8 a = *(const bf16x8*)(AT + (size_t)tok * AW + lane * 8); float v[8], s = 0.f;
#pragma unroll
      for (int j = 0; j < 8; ++j) { v[j] = bf2f((unsigned short)a[j]); s += v[j] * v[j]; }
      const float rstd = 1.f / sqrtf(wave_sum(s) * (1.f / AW) + RMS_EPS);
      u32x4 o; o.x = pk2(v[0] * rstd, v[1] * rstd); o.y = pk2(v[2] * rstd, v[3] * rstd); o.z = pk2(v[4] * rstd, v[5] * rstd); o.w = pk2(v[6] * rstd, v[7] * rstd);
      *(u32x4*)(MG + (size_t)tok * D + lane * 8) = o; }
    { const int c0 = lane * 8; float y[8], s = 0.f;
      const bf16_t* row = P + (size_t)tok * NIN;
      const bf16x8 u1 = *(const bf16x8*)(row + 3 * AW + c0), gb = *(const bf16x8*)(row + 3 * AW + CW + c0), c1 = *(const bf16x8*)(row + 3 * AW + 2 * CW + c0);
      bf16x8 u0 = {0, 0, 0, 0, 0, 0, 0, 0}, c0v = u0, u2 = u0, c2 = u0;
      if (i > 0) { u0 = *(const bf16x8*)(row - NIN + 3 * AW + c0); c0v = *(const bf16x8*)(row - NIN + 3 * AW + 2 * CW + c0); }
      if (i < SEQ - 1) { u2 = *(const bf16x8*)(row + NIN + 3 * AW + c0); c2 = *(const bf16x8*)(row + NIN + 3 * AW + 2 * CW + c0); }
#pragma unroll
      for (int j = 0; j < 8; ++j) { const float w0 = convw[c0 + j], w1 = convw[CW + c0 + j], w2 = convw[2 * CW + c0 + j];
          const float t = w0 * (bf2f((unsigned short)u0[j]) * bf2f((unsigned short)c0v[j])) + w1 * (bf2f((unsigned short)u1[j]) * bf2f((unsigned short)c1[j])) + w2 * (bf2f((unsigned short)u2[j]) * bf2f((unsigned short)c2[j]));
          y[j] = bf2f((unsigned short)gb[j]) * t; s += y[j] * y[j]; }
      const float rstd = 1.f / sqrtf(wave_sum(s) * (1.f / CW) + RMS_EPS);
      u32x4 o; o.x = pk2(y[0] * rstd, y[1] * rstd); o.y = pk2(y[2] * rstd, y[3] * rstd); o.z = pk2(y[4] * rstd, y[5] * rstd); o.w = pk2(y[6] * rstd, y[7] * rstd);
      *(u32x4*)(MG + (size_t)tok * D + AW + c0) = o; }
}

__global__ void __launch_bounds__(256) k_resid(const float* C, const float* xb, const float* g, float* xo, bf16_t* XN) {
    const int lane = threadIdx.x & 63, row = blockIdx.x * 4 + (threadIdx.x >> 6);
    if (row >= M) return;
    const f32x4* cr = (const f32x4*)(C + (size_t)row * D) + lane; const f32x4* xr = (const f32x4*)(xb + (size_t)row * D) + lane; const f32x4* gr = (const f32x4*)g + lane;
    f32x4 v[4]; float s = 0.f;
#pragma unroll
    for (int j = 0; j < 4; ++j) { v[j] = cr[64 * j]; s += (v[j].x * v[j].x + v[j].y * v[j].y) + (v[j].z * v[j].z + v[j].w * v[j].w); }
    const float rstd = 1.f / sqrtf(wave_sum(s) * (1.f / D) + RMS_EPS);
    float s2 = 0.f;
#pragma unroll
    for (int j = 0; j < 4; ++j) { v[j] = xr[64 * j] + gr[64 * j] * v[j] * rstd; s2 += (v[j].x * v[j].x + v[j].y * v[j].y) + (v[j].z * v[j].z + v[j].w * v[j].w); }
    const float rstd2 = 1.f / sqrtf(wave_sum(s2) * (1.f / D) + RMS_EPS);
    f32x4* orow = (f32x4*)(xo + (size_t)row * D) + lane;
    unsigned long long* o8 = (unsigned long long*)(XN + (size_t)row * D) + lane;
#pragma unroll
    for (int j = 0; j < 4; ++j) { orow[64 * j] = v[j];
        o8[64 * j] = (unsigned long long)pk2(v[j].x * rstd2, v[j].y * rstd2) | ((unsigned long long)pk2(v[j].z * rstd2, v[j].w * rstd2) << 32); }
}

extern "C" void kernel_launch(void* const* d_in, const int* in_sizes, int n_in, void* d_out, int out_size, void* d_ws, size_t ws_size, hipStream_t stream) {
    if (n_in != 13 || ws_size < WS_END) { fprintf(stderr, "kernel_launch: unexpected inputs (n_in %d, ws %zu)\n", n_in, ws_size); return; }
    Ptrs p{};
    p.x = (const float*)d_in[0]; p.pos = (const int*)d_in[1]; p.pre_mix = (const float*)d_in[2]; p.w_in = (const float*)d_in[3]; p.conv_w = (const float*)d_in[4];
    p.attn_norm = (const float*)d_in[5]; p.conv_norm = (const float*)d_in[6]; p.w_out = (const float*)d_in[7]; p.post_mix = (const float*)d_in[8]; p.pre_ffn = (const float*)d_in[9];
    p.w_gu = (const float*)d_in[10]; p.w_dn = (const float*)d_in[11]; p.post_ffn = (const float*)d_in[12]; p.out = (float*)d_out; p.ws = (unsigned char*)d_ws;
    unsigned char* ws = (unsigned char*)d_ws;
    bf16_t* XN = (bf16_t*)(ws + WS_XN); bf16_t* MG = (bf16_t*)(ws + WS_MG); bf16_t* P = (bf16_t*)(ws + WS_P); bf16_t* H = (bf16_t*)(ws + WS_H); float* TMP = (float*)(ws + WS_TMP);
    bf16_t* AT = (bf16_t*)(ws + WS_TMP);
    AT = (bf16_t*)(ws + WS_TMP + 32 * MiB);
    const float* rot = (const float*)(ws + WS_ROT);
    hipLaunchKernelGGL(k_prep, dim3(256), dim3(512), 0, stream, p);
    for (int l = 0; l < DEPTH; ++l) {
        const bf16_t* win = (const bf16_t*)(ws + WS_WIN) + (size_t)l * NIN * D; const bf16_t* wout = (const bf16_t*)(ws + WS_WOUT) + (size_t)l * D * D;
        const bf16_t* wgu = (const bf16_t*)(ws + WS_WGU) + (size_t)l * NGU * D; const bf16_t* wdn = (const bf16_t*)(ws + WS_WDN) + (size_t)l * D * FF;
        hipLaunchKernelGGL((k_gemm_naive<EpiInProjN, 1>), dim3((M / 16) * (NIN / 16) / 4), dim3(256), 0, stream, XN, win, NIN, D, EpiInProjN{P, rot});
        hipLaunchKernelGGL(k_attn_naive, dim3(M * NH / 256), dim3(256), 0, stream, P, AT);
        hipLaunchKernelGGL(k_merge, dim3(M / 4), dim3(256), 0, stream, P, AT, p.conv_w + (size_t)l * 3 * CW, MG);
        hipLaunchKernelGGL((k_gemm_naive<EpiF32N, 1>), dim3((M / 16) * (D / 16) / 4), dim3(256), 0, stream, MG, wout, D, D, EpiF32N{TMP});
        hipLaunchKernelGGL(k_resid, dim3(M / 4), dim3(256), 0, stream, TMP, l == 0 ? p.x : (const float*)p.out, p.post_mix + l * D, p.out, XN);
        hipLaunchKernelGGL((k_gemm_naive<EpiSwigluN, 2>), dim3((M / 16) * (NGU / 32) / 4), dim3(256), 0, stream, XN, wgu, NGU, D, EpiSwigluN{H});
        hipLaunchKernelGGL((k_gemm_naive<EpiF32N, 1>), dim3((M / 16) * (D / 16) / 4), dim3(256), 0, stream, H, wdn, D, FF, EpiF32N{TMP});
        hipLaunchKernelGGL(k_resid, dim3(M / 4), dim3(256), 0, stream, TMP, (const float*)p.out, p.post_ffn + l * D, p.out, XN);
    }
}
```
